# Optimizing an MI355X kernel written in HIP

```python
import math
import jax, jax.numpy as jnp
from jax import lax
import numpy as np

D_MODEL = 1024
BATCH = 16
SEQ = 2048
DEPTH = 1

D_MIX = D_MODEL
ATT_HEADS = 8
ATT_KV_HEADS = 2
ATT_HEAD_DIM = 64
ATT_WIDTH = ATT_HEADS * ATT_HEAD_DIM
ATT_KV_WIDTH = ATT_KV_HEADS * ATT_HEAD_DIM
WINDOW = 128
BLOCK = 128
REL_BUCKETS = 32
REL_MAX_DIST = 128
ML_HEADS = 4
ML_HEAD_DIM = 128
ML_WIDTH = ML_HEADS * ML_HEAD_DIM
ML_CHUNK = 128
CONV_WIDTH = 3
N_GATE_COLS = 4 * ML_HEADS
D_FF = 4 * D_MODEL
EPS = 1e-6

SPLITS = list(np.cumsum([ATT_WIDTH, ATT_KV_WIDTH, ATT_KV_WIDTH,
                         ML_WIDTH, ML_WIDTH, ML_WIDTH, ML_WIDTH]))
PROJ_WIDTH = ATT_WIDTH + 2 * ATT_KV_WIDTH + 4 * ML_WIDTH + N_GATE_COLS

kernel_name = 'hymba_swa_mlstm_bidir_block'


def rmsnorm(x, g):
    xf = x.astype(jnp.float32)
    y = xf * lax.rsqrt(jnp.mean(xf * xf, axis=-1, keepdims=True) + EPS)
    return (y * g.astype(jnp.float32)).astype(x.dtype)


def t5_bucket(rel):
    nb = REL_BUCKETS // 2
    max_exact = nb // 2
    ret = jnp.where(rel > 0, nb, 0)
    n = jnp.abs(rel)
    nf = jnp.maximum(n, 1).astype(jnp.float32)
    large = max_exact + (jnp.log(nf / max_exact) / math.log(REL_MAX_DIST / max_exact)
                         * (nb - max_exact)).astype(jnp.int32)
    large = jnp.minimum(large, nb - 1)
    return ret + jnp.where(n < max_exact, n, large)


def windowed_sink_attention(q, k, v, rel_bias, sink):
    B, S = q.shape[0], q.shape[1]
    nb = S // BLOCK
    G = ATT_HEADS // ATT_KV_HEADS
    qb = q.reshape(B, nb, BLOCK, ATT_KV_HEADS, G, ATT_HEAD_DIM)
    pad = ((0, 0), (BLOCK, BLOCK), (0, 0), (0, 0))
    kp = jnp.pad(k, pad).reshape(B, nb + 2, BLOCK, ATT_KV_HEADS, ATT_HEAD_DIM)
    vp = jnp.pad(v, pad).reshape(B, nb + 2, BLOCK, ATT_KV_HEADS, ATT_HEAD_DIM)
    kb = jnp.concatenate([kp[:, :-2], kp[:, 1:-1], kp[:, 2:]], axis=2)
    vb = jnp.concatenate([vp[:, :-2], vp[:, 1:-1], vp[:, 2:]], axis=2)
    s = jnp.einsum('bnqhgd,bnkhd->bnhgqk', qb, kb).astype(jnp.float32) * (ATT_HEAD_DIM ** -0.5)
    r = jnp.arange(BLOCK)[:, None]
    c = jnp.arange(3 * BLOCK)[None, :]
    rel = c - BLOCK - r
    bias = rel_bias.astype(jnp.float32)[t5_bucket(rel)]
    bias = bias.transpose(2, 0, 1).reshape(ATT_KV_HEADS, G, BLOCK, 3 * BLOCK)
    kpos = jnp.arange(nb)[:, None] * BLOCK - BLOCK + c
    valid = (jnp.abs(rel) <= WINDOW)[None] & ((kpos >= 0) & (kpos < S))[:, None, :]
    s = jnp.where(valid[None, :, None, None], s + bias[None, None], -jnp.inf)
    sink_l = sink.astype(jnp.float32).reshape(ATT_KV_HEADS, G)[None, None, :, :, None, None]
    m = jnp.maximum(jnp.max(s, axis=-1, keepdims=True), sink_l)
    p = jnp.exp(s - m)
    p = p / (jnp.sum(p, axis=-1, keepdims=True) + jnp.exp(sink_l - m))
    o = jnp.einsum('bnhgqk,bnkhd->bnqhgd', p.astype(v.dtype), vb)
    return o.reshape(B, S, ATT_WIDTH)


def mlstm_scan(q, k, v, log_i, log_f):
    B, H, S, d = q.shape
    nc = S // ML_CHUNK
    L = ML_CHUNK

    def to_chunks(a):
        return jnp.moveaxis(a.reshape((B, H, nc, L) + a.shape[3:]), 2, 0)

    xs = (to_chunks(q), to_chunks(k), to_chunks(v), to_chunks(log_i), to_chunks(log_f))
    lower = jnp.tril(jnp.ones((L, L), dtype=bool))

    def step(carry, inp):
        C, n, m = carry
        qt, kt, vt, li, lf = inp
        b = jnp.cumsum(lf, axis=-1)
        D = jnp.where(lower, b[..., :, None] - b[..., None, :] + li[..., None, :], -jnp.inf)
        inter = b + m[..., None]
        m_t = jnp.maximum(inter, jnp.max(D, axis=-1))
        w_inter = jnp.exp(inter - m_t)
        qk = jnp.einsum('bhtd,bhsd->bhts', qt, kt) * jnp.exp(D - m_t[..., None])
        num = (jnp.einsum('bhts,bhse->bhte', qk, vt)
               + w_inter[..., None] * jnp.einsum('bhtd,bhde->bhte', qt, C))
        den = jnp.sum(qk, axis=-1) + w_inter * jnp.einsum('bhtd,bhd->bht', qt, n)
        h = num / jnp.maximum(jnp.abs(den), jnp.exp(-m_t))[..., None]
        bL = b[..., -1]
        a = bL[..., None] - b + li
        m_new = jnp.maximum(bL + m, jnp.max(a, axis=-1))
        decay = jnp.exp(bL + m - m_new)
        ws = jnp.exp(a - m_new[..., None])
        C = decay[..., None, None] * C + jnp.einsum('bhs,bhsd,bhse->bhde', ws, kt, vt)
        n = decay[..., None] * n + jnp.einsum('bhs,bhsd->bhd', ws, kt)
        return (C, n, m_new), h

    init = (jnp.zeros((B, H, d, d), jnp.float32), jnp.zeros((B, H, d), jnp.float32),
            jnp.zeros((B, H), jnp.float32))
    _, h = lax.scan(step, init, xs)
    return jnp.moveaxis(h, 0, 2).reshape(B, H, S, d)


def centred_depthwise_conv(x, w):
    half = CONV_WIDTH // 2
    return lax.conv_general_dilated(x, w[:, None, :].astype(x.dtype), window_strides=(1,),
                                    padding=[(half, half)],
                                    dimension_numbers=('NWC', 'WIO', 'NWC'),
                                    feature_group_count=x.shape[-1])


def mlstm_mixer(q_in, k_in, v_in, o_pre, gate_pre, gate_bias, conv_w, norm_g):
    B, S = q_in.shape[0], q_in.shape[1]
    qk = jax.nn.silu(centred_depthwise_conv(jnp.concatenate([q_in, k_in], axis=-1), conv_w))

    def heads(a):
        return a.astype(jnp.float32).reshape(B, S, ML_HEADS, ML_HEAD_DIM).transpose(0, 2, 1, 3)

    q = heads(qk[..., :ML_WIDTH])
    k = heads(qk[..., ML_WIDTH:]) * (ML_HEAD_DIM ** -0.5)
    v = heads(v_in)
    g = (gate_pre.astype(jnp.float32) + gate_bias.astype(jnp.float32))
    g = g.reshape(B, S, 4, ML_HEADS).transpose(2, 0, 3, 1)
    i_f, f_f, i_b, f_b = g[0], g[1], g[2], g[3]
    h_f = mlstm_scan(q, k, v, i_f, jax.nn.log_sigmoid(f_f))
    flip = lambda a: jnp.flip(a, axis=2)
    h_b = flip(mlstm_scan(flip(q), flip(k), flip(v), flip(i_b), flip(jax.nn.log_sigmoid(f_b))))
    h = h_f + h_b
    h = h * lax.rsqrt(jnp.mean(h * h, axis=-1, keepdims=True) + EPS)
    h = h * norm_g.astype(jnp.float32).reshape(ML_HEADS, 1, ML_HEAD_DIM)
    h = h.transpose(0, 2, 1, 3).reshape(B, S, ML_WIDTH)
    return (jax.nn.sigmoid(o_pre.astype(jnp.float32)) * h).astype(v_in.dtype)


def setup_inputs(seed: int = 0) -> dict:
    key = jax.random.key(seed)
    ks = jax.random.split(key, 16)
    f32 = jnp.float32
    nrm = lambda k_, shape: jax.random.normal(k_, shape, f32)
    x = nrm(ks[0], (BATCH, SEQ, D_MODEL))
    norm1_g = 1.0 + 0.02 * nrm(ks[1], (DEPTH, D_MODEL))
    w_in = nrm(ks[2], (DEPTH, D_MODEL, PROJ_WIDTH)) * D_MODEL ** -0.5
    i_bias = 0.1 * nrm(ks[3], (DEPTH, 2, ML_HEADS))
    f_bias = jnp.linspace(3.0, 6.0, ML_HEADS, dtype=f32) + 0.1 * nrm(ks[4], (DEPTH, 2, ML_HEADS))
    b_gates = jnp.stack([i_bias[:, 0], f_bias[:, 0], i_bias[:, 1], f_bias[:, 1]],
                        axis=1).reshape(DEPTH, N_GATE_COLS)
    conv_w = nrm(ks[5], (DEPTH, CONV_WIDTH, 2 * ML_WIDTH)) * CONV_WIDTH ** -0.5
    ml_norm_g = 1.0 + 0.02 * nrm(ks[6], (DEPTH, ML_WIDTH))
    sink_logits = nrm(ks[7], (DEPTH, ATT_HEADS))
    w_out = nrm(ks[8], (DEPTH, D_MIX, D_MODEL)) * D_MIX ** -0.5
    norm2_g = 1.0 + 0.02 * nrm(ks[9], (DEPTH, D_MODEL))
    w_up = nrm(ks[10], (DEPTH, D_MODEL, D_FF)) * D_MODEL ** -0.5
    w_down = nrm(ks[11], (DEPTH, D_FF, D_MODEL)) * D_FF ** -0.5
    rel_bias = 0.5 * nrm(ks[12], (REL_BUCKETS, ATT_HEADS))
    final_g = 1.0 + 0.02 * nrm(ks[13], (D_MODEL,))
    return {'x': x, 'norm1_g': norm1_g, 'w_in': w_in, 'b_gates': b_gates, 'conv_w': conv_w,
            'ml_norm_g': ml_norm_g, 'sink_logits': sink_logits, 'w_out': w_out,
            'norm2_g': norm2_g, 'w_up': w_up, 'w_down': w_down, 'rel_bias': rel_bias,
            'final_g': final_g}


def reference(x, norm1_g, w_in, b_gates, conv_w, ml_norm_g, sink_logits, w_out,
              norm2_g, w_up, w_down, rel_bias, final_g):
    B, S = x.shape[0], x.shape[1]
    for l in range(DEPTH):
        u = rmsnorm(x, norm1_g[l])
        proj = u @ w_in[l]
        q_a, k_a, v_a, q_m, k_m, v_m, o_m, g_m = jnp.split(proj, SPLITS, axis=-1)
        att = windowed_sink_attention(
            q_a.reshape(B, S, ATT_HEADS, ATT_HEAD_DIM),
            k_a.reshape(B, S, ATT_KV_HEADS, ATT_HEAD_DIM),
            v_a.reshape(B, S, ATT_KV_HEADS, ATT_HEAD_DIM),
            rel_bias, sink_logits[l])
        ml = mlstm_mixer(q_m, k_m, v_m, o_m, g_m, b_gates[l], conv_w[l], ml_norm_g[l])
        x = x + jnp.concatenate([att, ml], axis=-1) @ w_out[l]
        hid = rmsnorm(x, norm2_g[l]) @ w_up[l]
        x = x + jnp.square(jax.nn.relu(hid)) @ w_down[l]
    return rmsnorm(x, final_g)
```

```cpp
#include <hip/hip_runtime.h>
#include <cstdint>
#include <cstdio>

#ifndef BUCKET_DOWN
#define BUCKET_DOWN 0
#endif

constexpr int DM = 1024, NB = 16, SEQ = 2048, M = NB * SEQ;
constexpr int PROJ = 2832;
constexpr int AH = 8, AKV = 2, AHD = 64;
constexpr int MH = 4, MHD = 128;
constexpr int DFF = 4096;
constexpr float EPS = 1e-6f;
constexpr int C_QA = 0, C_KA = 512, C_VA = 640, C_QM = 768, C_KM = 1280, C_VM = 1792, C_OM = 2304, C_G = 2816;

__device__ __forceinline__ float wave_sum(float v) {
#pragma unroll
    for (int o = 1; o < 64; o <<= 1) v += __shfl_xor(v, o);
    return v;
}

__global__ void __launch_bounds__(256) rmsnorm_k(const float* __restrict__ x, const float* __restrict__ g, float* __restrict__ out, int rows) {
    const int lane = threadIdx.x & 63, w = (blockIdx.x * blockDim.x + threadIdx.x) >> 6, nw = (gridDim.x * blockDim.x) >> 6;
    for (int r = w; r < rows; r += nw) {
        const float4* xr = (const float4*)(x + (size_t)r * DM);
        float4 v[4]; float s = 0.f;
#pragma unroll
        for (int j = 0; j < 4; ++j) { v[j] = xr[lane + 64 * j]; s += v[j].x * v[j].x + v[j].y * v[j].y + v[j].z * v[j].z + v[j].w * v[j].w; }
        s = wave_sum(s);
        const float rs = rsqrtf(s * (1.f / DM) + EPS);
        float4* o = (float4*)(out + (size_t)r * DM);
#pragma unroll
        for (int j = 0; j < 4; ++j) { const float4 gg = ((const float4*)g)[lane + 64 * j]; float4 t; t.x = v[j].x * rs * gg.x; t.y = v[j].y * rs * gg.y; t.z = v[j].z * rs * gg.z; t.w = v[j].w * rs * gg.w; o[lane + 64 * j] = t; }
    }
}

template <int EPI>
__global__ void __launch_bounds__(256) gemm_k(const float* __restrict__ A, int lda, const float* __restrict__ B, int ldb, float* __restrict__ C, int ldc, const float* __restrict__ R, int ldr, int Mr, int N, int K) {
    __shared__ float As[16][64 + 4];
    __shared__ float Bs[16][64 + 4];
    const int tx = threadIdx.x & 15, ty = threadIdx.x >> 4;
    const int m0 = blockIdx.y * 64, n0 = blockIdx.x * 64;
    float acc[4][4] = {};
    for (int k0 = 0; k0 < K; k0 += 16) {
        {
            const int r = threadIdx.x >> 2, c4 = (threadIdx.x & 3) * 4;
            const float4 a = *(const float4*)(A + (size_t)(m0 + r) * lda + k0 + c4);
            As[c4 + 0][r] = a.x; As[c4 + 1][r] = a.y; As[c4 + 2][r] = a.z; As[c4 + 3][r] = a.w;
        }
        {
            const int r = threadIdx.x >> 4, c4 = (threadIdx.x & 15) * 4;
            float4 b = {0.f, 0.f, 0.f, 0.f};
            if (n0 + c4 < N) b = *(const float4*)(B + (size_t)(k0 + r) * ldb + n0 + c4);
            Bs[r][c4 + 0] = b.x; Bs[r][c4 + 1] = b.y; Bs[r][c4 + 2] = b.z; Bs[r][c4 + 3] = b.w;
        }
        __syncthreads();
#pragma unroll
        for (int kk = 0; kk < 16; ++kk) {
            float a[4], b[4];
#pragma unroll
            for (int i = 0; i < 4; ++i) a[i] = As[kk][ty * 4 + i];
#pragma unroll
            for (int j = 0; j < 4; ++j) b[j] = Bs[kk][tx * 4 + j];
#pragma unroll
            for (int i = 0; i < 4; ++i)
#pragma unroll
                for (int j = 0; j < 4; ++j) acc[i][j] = fmaf(a[i], b[j], acc[i][j]);
        }
        __syncthreads();
    }
#pragma unroll
    for (int i = 0; i < 4; ++i) {
        const int m = m0 + ty * 4 + i;
#pragma unroll
        for (int j = 0; j < 4; ++j) {
            const int n = n0 + tx * 4 + j;
            if (n < N) {
                float v = acc[i][j];
                if (EPI == 1) v += R[(size_t)m * ldr + n];
                if (EPI == 2) { v = v > 0.f ? v : 0.f; v = v * v; }
                C[(size_t)m * ldc + n] = v;
            }
        }
    }
}

__device__ __forceinline__ int t5_bucket(int rel) {
    const int n = rel < 0 ? -rel : rel;
    int b;
    if (n < 8) b = n;
    else if (n < 12) b = 8;
    else if (n < 16 + BUCKET_DOWN) b = 9;
    else if (n < 23) b = 10;
    else if (n < 32 + BUCKET_DOWN) b = 11;
    else if (n < 46) b = 12;
    else if (n < 64 + BUCKET_DOWN) b = 13;
    else if (n < 91) b = 14;
    else b = 15;
    return b + (rel > 0 ? 16 : 0);
}

__global__ void __launch_bounds__(64) attn_k(const float* __restrict__ proj, const float* __restrict__ rel_bias, const float* __restrict__ sink, float* __restrict__ mix) {
    const int idx = blockIdx.x * blockDim.x + threadIdx.x;
    const int t = idx % SEQ, bh = idx / SEQ, h = bh % AH, b = bh / AH;
    const int kvh = h / (AH / AKV);
    const size_t row = (size_t)b * SEQ + t;
    float q[AHD];
    const float* qp = proj + row * PROJ + C_QA + h * AHD;
#pragma unroll
    for (int d = 0; d < AHD; ++d) q[d] = qp[d];
    const float sk = sink[h];
    float m = sk, l = 1.0f;
    float o[AHD];
#pragma unroll
    for (int d = 0; d < AHD; ++d) o[d] = 0.f;
    const int lo = t - 128 < 0 ? 0 : t - 128, hi = t + 128 > SEQ - 1 ? SEQ - 1 : t + 128;
    for (int s = lo; s <= hi; ++s) {
        const float* kp = proj + ((size_t)b * SEQ + s) * PROJ + C_KA + kvh * AHD;
        const float* vp = proj + ((size_t)b * SEQ + s) * PROJ + C_VA + kvh * AHD;
        float sc = 0.f;
#pragma unroll
        for (int d = 0; d < AHD; ++d) sc = fmaf(q[d], kp[d], sc);
        sc = sc * 0.125f + rel_bias[t5_bucket(s - t) * AH + h];
        const float mn = fmaxf(m, sc);
        const float f = __expf(m - mn), p = __expf(sc - mn);
        l = l * f + p;
#pragma unroll
        for (int d = 0; d < AHD; ++d) o[d] = o[d] * f + p * vp[d];
        m = mn;
    }
    const float inv = 1.f / l;
    float* op = mix + row * DM + h * AHD;
#pragma unroll
    for (int d = 0; d < AHD; ++d) op[d] = o[d] * inv;
}

__global__ void __launch_bounds__(256) conv_k(const float* __restrict__ proj, const float* __restrict__ conv_w, float* __restrict__ qk) {
    const size_t i = (size_t)blockIdx.x * blockDim.x + threadIdx.x;
    const int c = (int)(i % 1024); const size_t row = i / 1024; const int t = (int)(row % SEQ);
    const float* p = proj + row * PROJ + C_QM + c;
    float a = conv_w[1 * 1024 + c] * p[0];
    if (t > 0) a += conv_w[0 * 1024 + c] * p[-PROJ];
    if (t < SEQ - 1) a += conv_w[2 * 1024 + c] * p[PROJ];
    float s = a / (1.f + __expf(-a));
    if (c >= 512) s *= 0.08838834764831845f;
    qk[i] = s;
}

__global__ void __launch_bounds__(256) mlstm_k(float* proj, const float* __restrict__ qk, const float* __restrict__ b_gates, float* mix) {
    const int dir = blockIdx.x & 1, h = (blockIdx.x >> 1) & 3, b = blockIdx.x >> 3;
    const int tid = threadIdx.x, e = tid & 127, dh = tid >> 7;
    __shared__ float sq[128], sk[128], part[2][128], pden[2];
    float C[64], n[64];
#pragma unroll
    for (int i = 0; i < 64; ++i) { C[i] = 0.f; n[i] = 0.f; }
    float m = 0.f;
    const float bi = b_gates[(dir * 2 + 0) * 4 + h], bf = b_gates[(dir * 2 + 1) * 4 + h];
    for (int step = 0; step < SEQ; ++step) {
        const int t = dir ? SEQ - 1 - step : step;
        const size_t row = (size_t)b * SEQ + t;
        if (tid < 128) sq[tid] = qk[row * 1024 + h * 128 + tid];
        else sk[tid - 128] = qk[row * 1024 + 512 + h * 128 + (tid - 128)];
        const float v = proj[row * PROJ + C_VM + h * 128 + e];
        const float li = proj[row * PROJ + C_G + (dir * 2 + 0) * 4 + h] + bi;
        const float fp = proj[row * PROJ + C_G + (dir * 2 + 1) * 4 + h] + bf;
        const float lf = fminf(fp, 0.f) - log1pf(__expf(-fabsf(fp)));
        const float mn = fmaxf(lf + m, li);
        const float fg = __expf(lf + m - mn), ig = __expf(li - mn);
        m = mn;
        __syncthreads();
        float acc = 0.f, dn = 0.f;
#pragma unroll
        for (int i = 0; i < 64; ++i) {
            const float kd = sk[dh * 64 + i], qd = sq[dh * 64 + i];
            C[i] = fg * C[i] + ig * kd * v;
            n[i] = fg * n[i] + ig * kd;
            acc = fmaf(qd, C[i], acc);
            dn = fmaf(qd, n[i], dn);
        }
        part[dh][e] = acc;
        if (e == 0) pden[dh] = dn;
        __syncthreads();
        if (tid < 128) {
            const float num = part[0][tid] + part[1][tid], den = pden[0] + pden[1];
            const float hv = num / fmaxf(fabsf(den), __expf(-m));
            if (dir == 0) mix[row * DM + 512 + h * 128 + tid] = hv;
            else proj[row * PROJ + C_QM + h * 128 + tid] = hv;
        }
    }
}

__global__ void __launch_bounds__(256) fin_k(const float* proj, const float* __restrict__ norm_g, float* mix) {
    const int lane = threadIdx.x & 63; const size_t w = ((size_t)blockIdx.x * blockDim.x + threadIdx.x) >> 6;
    const size_t row = w / 4; const int h = (int)(w % 4);
    const float* hf = mix + row * DM + 512 + h * 128; const float* hb = proj + row * PROJ + C_QM + h * 128;
    const float a0 = hf[lane] + hb[lane], a1 = hf[lane + 64] + hb[lane + 64];
    const float ss = wave_sum(a0 * a0 + a1 * a1);
    const float rs = rsqrtf(ss * (1.f / 128.f) + EPS);
    const float* op = proj + row * PROJ + C_OM + h * 128;
    const float o0 = 1.f / (1.f + __expf(-op[lane])), o1 = 1.f / (1.f + __expf(-op[lane + 64]));
    float* mp = mix + row * DM + 512 + h * 128;
    mp[lane] = o0 * a0 * rs * norm_g[h * 128 + lane];
    mp[lane + 64] = o1 * a1 * rs * norm_g[h * 128 + lane + 64];
}

extern "C" void kernel_launch(void* const* d_in, const int* in_sizes, int n_in, void* d_out, int out_size, void* d_ws, size_t ws_size, hipStream_t stream) {
    const float* x = (const float*)d_in[0]; const float* norm1_g = (const float*)d_in[1]; const float* w_in = (const float*)d_in[2];
    const float* b_gates = (const float*)d_in[3]; const float* conv_w = (const float*)d_in[4]; const float* ml_norm_g = (const float*)d_in[5];
    const float* sink = (const float*)d_in[6]; const float* w_out = (const float*)d_in[7]; const float* norm2_g = (const float*)d_in[8];
    const float* w_up = (const float*)d_in[9]; const float* w_down = (const float*)d_in[10]; const float* rel_bias = (const float*)d_in[11];
    const float* final_g = (const float*)d_in[12];
    float* out = (float*)d_out;
    char* ws = (char*)d_ws;
    const size_t MiB = 1u << 20;
    float* U = (float*)(ws);
    float* PROJB = (float*)(ws + 128 * MiB);
    float* QKB = out;
    float* MIX = U;
    if (ws_size < (size_t)482 * MiB) { fprintf(stderr, "ws too small: %zu\n", ws_size); return; }
    rmsnorm_k<<<2048, 256, 0, stream>>>(x, norm1_g, U, M);
    gemm_k<0><<<dim3((PROJ + 63) / 64, M / 64), 256, 0, stream>>>(U, DM, w_in, PROJ, PROJB, PROJ, nullptr, 0, M, PROJ, DM);
    attn_k<<<(M * AH) / 64, 64, 0, stream>>>(PROJB, rel_bias, sink, MIX);
    conv_k<<<(int)(((size_t)M * 1024) / 256), 256, 0, stream>>>(PROJB, conv_w, QKB);
    mlstm_k<<<NB * MH * 2, 256, 0, stream>>>(PROJB, QKB, b_gates, MIX);
    fin_k<<<(int)(((size_t)M * 4 * 64) / 256), 256, 0, stream>>>(PROJB, ml_norm_g, MIX);
    gemm_k<1><<<dim3(DM / 64, M / 64), 256, 0, stream>>>(MIX, DM, w_out, DM, out, DM, x, DM, M, DM, DM);
    float* XN = (float*)(ws);
    float* HID = (float*)(ws + 128 * MiB);
    for (int half = 0; half < 2; ++half) {
        float* x1 = out + (size_t)half * (M / 2) * DM;
        rmsnorm_k<<<2048, 256, 0, stream>>>(x1, norm2_g, XN, M / 2);
        gemm_k<2><<<dim3(DFF / 64, (M / 2) / 64), 256, 0, stream>>>(XN, DM, w_up, DFF, HID, DFF, nullptr, 0, M / 2, DFF, DM);
        gemm_k<1><<<dim3(DM / 64, (M / 2) / 64), 256, 0, stream>>>(HID, DFF, w_down, DM, x1, DM, x1, DM, M / 2, DM, DFF);
        rmsnorm_k<<<2048, 256, 0, stream>>>(x1, final_g, x1, M / 2);
    }
}
```
